# Optimizing an MI355X kernel written in HIP

```python
import jax, jax.numpy as jnp
from jax import lax
import numpy as np

D_MODEL = 1024
BATCH = 2
SEQ = 8192
DEPTH = 1
DEC_BATCH = 128
DEC_SEQ = 4
PAST_LEN = 8192
PAGE_SIZE = 128

HEAD_DIM = 64
CONV_W = D_MODEL // 4
ATTN_W = D_MODEL // 2
MEM_W = D_MODEL // 4
ATTN_HEADS = ATTN_W // HEAD_DIM
MEM_HEADS = MEM_W // HEAD_DIM
CONV_GROUPS = CONV_W // HEAD_DIM
D_MIX = CONV_W + ATTN_W + MEM_W
CONV_WIDTH = 3
N_MEM = 256
DILATED_CONFIGS = ((128, 1), (512, 4), (2048, 16))
WINDOW_MAX = 2048
ATTN_BLOCK = 128
ALIBI_MAX = 8.0
RMS_EPS = 1e-6
SPLITS = (CONV_W, CONV_W, CONV_W, ATTN_W, ATTN_W, ATTN_W, MEM_W, D_MIX)
D_IN = sum(SPLITS)

kernel_name = "hymba_conv_dilated_alibi_memxattn_step"

F32 = jnp.float32


def _rmsnorm(x, g):
    xf = x.astype(F32)
    r = lax.rsqrt(jnp.mean(xf * xf, axis=-1, keepdims=True) + RMS_EPS)
    return (xf * r * g.astype(F32)).astype(x.dtype)


def _alibi_slopes():
    h = jnp.arange(ATTN_HEADS, dtype=F32) + 1.0
    return jnp.exp2(-ALIBI_MAX * h / ATTN_HEADS)


def _project(x, g_in, w_in):
    h = _rmsnorm(x, g_in)
    p = h @ w_in
    idx = np.cumsum(SPLITS)[:-1].tolist()
    cb, cc, ch, q, k, v, mq, z = jnp.split(p, idx, axis=-1)
    lead = x.shape[:2]
    q = q.reshape(lead + (ATTN_HEADS, HEAD_DIM))
    k = k.reshape(lead + (ATTN_HEADS, HEAD_DIM))
    v = v.reshape(lead + (ATTN_HEADS, HEAD_DIM))
    mq = mq.reshape(lead + (MEM_HEADS, HEAD_DIM))
    return cb, cc, ch, q, k, v, mq, z


def _conv3(full, w):
    return w[0] * full[:, :-2] + w[1] * full[:, 1:-1] + w[2] * full[:, 2:]


def _dilated_band(q, k, v, win, dil, slopes):
    B, T, H, E = q.shape
    span = win // dil
    L = T // dil
    nb = -(-L // ATTN_BLOCK)
    Lp = nb * ATTN_BLOCK

    def fold(a):
        a = a.reshape(B, L, dil, H, E).transpose(0, 2, 1, 3, 4)
        a = jnp.pad(a, ((0, 0), (0, 0), (0, Lp - L), (0, 0), (0, 0)))
        return a.reshape(B, dil, nb, ATTN_BLOCK, H, E)

    def with_prev(a):
        prev = jnp.pad(a, ((0, 0), (0, 0), (1, 0), (0, 0), (0, 0), (0, 0)))[:, :, :-1]
        return jnp.concatenate([prev, a], axis=3)

    qb = fold(q)
    kk = with_prev(fold(k))
    vv = with_prev(fold(v))
    s = jnp.einsum('brnqhe,brnkhe->brnhqk', qb, kk, preferred_element_type=F32) * (HEAD_DIM ** -0.5)
    qi = jnp.arange(ATTN_BLOCK)[:, None] + ATTN_BLOCK
    ki = jnp.arange(2 * ATTN_BLOCK)[None, :]
    dist = qi - ki
    kglob = jnp.arange(nb)[:, None, None] * ATTN_BLOCK + ki - ATTN_BLOCK
    valid = (dist >= 0) & (dist <= span) & (kglob >= 0)
    bias = -(slopes * dil)[:, None, None] * dist
    s = jnp.where(valid[:, None], s + bias, -jnp.inf)
    m = jnp.max(s, axis=-1, keepdims=True)
    p = jnp.exp(s - m)
    l = jnp.sum(p, axis=-1, keepdims=True)
    o = jnp.einsum('brnhqk,brnkhe->brnqhe', p, vv.astype(F32))
    l_t = jnp.transpose(l[..., 0], (0, 1, 2, 4, 3))[..., None]
    o = o / l_t
    lse = jnp.transpose((m + jnp.log(l))[..., 0], (0, 1, 2, 4, 3))
    o = o.reshape(B, dil, Lp, H, E)[:, :, :L].transpose(0, 2, 1, 3, 4).reshape(B, T, H, E)
    lse = lse.reshape(B, dil, Lp, H)[:, :, :L].transpose(0, 2, 1, 3).reshape(B, T, H)
    return o, lse


def _dilated_gather(q, kfull, vfull, win, dil, slopes, n_buf):
    S = q.shape[1]
    span = win // dil
    j = jnp.arange(S)[:, None]
    kd = jnp.arange(span + 1)[None, :]
    idx = n_buf + j - kd * dil
    valid = idx >= 0
    idx = jnp.maximum(idx, 0)
    kg = kfull[:, idx]
    vg = vfull[:, idx]
    s = jnp.einsum('bshe,bskhe->bhsk', q, kg, preferred_element_type=F32) * (HEAD_DIM ** -0.5)
    s = s - (slopes * dil)[:, None, None] * kd
    s = jnp.where(valid, s, -jnp.inf)
    m = jnp.max(s, axis=-1, keepdims=True)
    p = jnp.exp(s - m)
    l = jnp.sum(p, axis=-1, keepdims=True)
    o = jnp.einsum('bhsk,bskhe->bshe', p, vg.astype(F32))
    o = o / jnp.transpose(l[..., 0], (0, 2, 1))[..., None]
    lse = jnp.transpose((m + jnp.log(l))[..., 0], (0, 2, 1))
    return o, lse


def _merge_by_denominator(outs, lses):
    o = jnp.stack(outs, 0)
    a = jax.nn.softmax(jnp.stack(lses, 0), axis=0)
    return jnp.sum(a[..., None] * o, axis=0)


def _mem_attn(qm, mk, mv):
    s = jnp.einsum('bthe,bmhe->bhtm', qm, mk, preferred_element_type=F32) * (HEAD_DIM ** -0.5)
    p = jax.nn.softmax(s, axis=-1)
    return jnp.einsum('bhtm,bmhe->bthe', p, mv.astype(F32))


def _mem_kv(mem, g_mem, w_mem_kv):
    kv = _rmsnorm(mem, g_mem) @ w_mem_kv
    mk, mv = jnp.split(kv, 2, axis=-1)
    lead = mem.shape[:2]
    return mk.reshape(lead + (MEM_HEADS, HEAD_DIM)), mv.reshape(lead + (MEM_HEADS, HEAD_DIM))


def _finish(x, conv_y, attn_o, mem_o, z, w_out):
    lead = x.shape[:2]
    mix = jnp.concatenate([conv_y,
                           attn_o.reshape(lead + (ATTN_W,)).astype(x.dtype),
                           mem_o.reshape(lead + (MEM_W,)).astype(x.dtype)], axis=-1)
    mix = mix * jax.nn.silu(z)
    return x + mix @ w_out


def setup_inputs(seed: int = 0) -> dict:
    key = jax.random.key(seed)
    ks = jax.random.split(key, 20)
    n_buf = min(WINDOW_MAX, PAST_LEN)
    nrm = jax.random.normal
    return {
        "x_prompt": nrm(ks[0], (BATCH, SEQ, D_MODEL), F32),
        "x_sample": nrm(ks[1], (DEC_BATCH, DEC_SEQ, D_MODEL), F32),
        "mem_prompt": nrm(ks[2], (BATCH, N_MEM, D_MODEL), F32),
        "cache_win_k": nrm(ks[3], (DEPTH, DEC_BATCH, n_buf, ATTN_HEADS, HEAD_DIM), F32),
        "cache_win_v": nrm(ks[4], (DEPTH, DEC_BATCH, n_buf, ATTN_HEADS, HEAD_DIM), F32),
        "cache_conv": nrm(ks[5], (DEPTH, DEC_BATCH, CONV_WIDTH - 1, CONV_W), F32),
        "cache_mem_k": nrm(ks[6], (DEPTH, DEC_BATCH, N_MEM, MEM_HEADS, HEAD_DIM), F32),
        "cache_mem_v": nrm(ks[7], (DEPTH, DEC_BATCH, N_MEM, MEM_HEADS, HEAD_DIM), F32),
        "g_in": 1.0 + 0.02 * nrm(ks[8], (DEPTH, D_MODEL), F32),
        "w_in": nrm(ks[9], (DEPTH, D_MODEL, D_IN), F32) * D_MODEL ** -0.5,
        "conv_w": nrm(ks[10], (DEPTH, CONV_WIDTH, CONV_W), F32) * CONV_WIDTH ** -0.5,
        "g_mem": 1.0 + 0.02 * nrm(ks[11], (DEPTH, D_MODEL), F32),
        "w_mem_kv": nrm(ks[12], (DEPTH, D_MODEL, 2 * MEM_W), F32) * D_MODEL ** -0.5,
        "w_out": nrm(ks[13], (DEPTH, D_MIX, D_MODEL), F32) * D_MIX ** -0.5,
        "g_final": 1.0 + 0.02 * nrm(ks[14], (D_MODEL,), F32),
    }


def reference(x_prompt, x_sample, mem_prompt, cache_win_k, cache_win_v, cache_conv,
              cache_mem_k, cache_mem_v, g_in, w_in, conv_w, g_mem, w_mem_kv, w_out, g_final):
    slopes = _alibi_slopes()
    xp, xs = x_prompt, x_sample
    n_buf = cache_win_k.shape[2]
    p_wk, p_wv, p_cv, p_mk, p_mv, s_wk, s_wv, s_cv = [], [], [], [], [], [], [], []
    for l in range(DEPTH):
        cb, cc, ch, q, k, v, mq, z = _project(xp, g_in[l], w_in[l])
        u = cc * ch
        up = jnp.pad(u, ((0, 0), (CONV_WIDTH - 1, 0), (0, 0)))
        conv_y = cb * _conv3(up, conv_w[l])
        outs, lses = [], []
        for win, dil in DILATED_CONFIGS:
            o, lse = _dilated_band(q, k, v, win, dil, slopes)
            outs.append(o)
            lses.append(lse)
        attn_o = _merge_by_denominator(outs, lses)
        mk, mv = _mem_kv(mem_prompt, g_mem[l], w_mem_kv[l])
        mem_o = _mem_attn(mq, mk, mv)
        n_keep = min(WINDOW_MAX, xp.shape[1])
        p_wk.append(k[:, -n_keep:])
        p_wv.append(v[:, -n_keep:])
        p_cv.append(u[:, -(CONV_WIDTH - 1):])
        p_mk.append(mk)
        p_mv.append(mv)
        xp = _finish(xp, conv_y, attn_o, mem_o, z, w_out[l])

        cb, cc, ch, q, k, v, mq, z = _project(xs, g_in[l], w_in[l])
        u = cc * ch
        full = jnp.concatenate([cache_conv[l].astype(u.dtype), u], axis=1)
        conv_y = cb * _conv3(full, conv_w[l])
        kfull = jnp.concatenate([cache_win_k[l].astype(k.dtype), k], axis=1)
        vfull = jnp.concatenate([cache_win_v[l].astype(v.dtype), v], axis=1)
        outs, lses = [], []
        for win, dil in DILATED_CONFIGS:
            o, lse = _dilated_gather(q, kfull, vfull, win, dil, slopes, n_buf)
            outs.append(o)
            lses.append(lse)
        attn_o = _merge_by_denominator(outs, lses)
        mem_o = _mem_attn(mq, cache_mem_k[l].astype(mq.dtype), cache_mem_v[l].astype(mq.dtype))
        s_wk.append(k)
        s_wv.append(v)
        s_cv.append(full[:, -(CONV_WIDTH - 1):])
        xs = _finish(xs, conv_y, attn_o, mem_o, z, w_out[l])

    y_prompt = _rmsnorm(xp, g_final)
    y_sample = _rmsnorm(xs, g_final)
    return (y_prompt, y_sample,
            jnp.stack(p_wk, 0), jnp.stack(p_wv, 0), jnp.stack(p_cv, 0),
            jnp.stack(p_mk, 0), jnp.stack(p_mv, 0),
            jnp.stack(s_wk, 0), jnp.stack(s_wv, 0), jnp.stack(s_cv, 0))
```

```cpp
#include <hip/hip_runtime.h>
#include <cstdio>
#include <cstdint>
namespace pg8 {
#define PG8_LAS __attribute__((address_space(3)))
typedef unsigned short bf16_t;
typedef short bf16x8 __attribute__((ext_vector_type(8)));
typedef float f32x4 __attribute__((ext_vector_type(4)));
typedef unsigned u32x4 __attribute__((ext_vector_type(4)));
constexpr int BM = 256, BK = 64, HALF = 128, HTB = HALF * BK * 2  , STAGE_BYTES = 8 * HTB, NXCD = 8, WGM = 8;

__host__ __device__ __forceinline__ int lds_byte(int r, int c) { const int st = (r >> 4) * 2 + (c >> 5), rr = r & 15, cc = c & 31, ob = rr * 64 + cc * 2; return st * 1024 + (ob ^ (((ob >> 9) & 1) << 5)); }
__host__ __device__ __forceinline__ void stage_rc(int b, int& R, int& C) { const int st = b / 1024, sb = b % 1024, swz = sb ^ (((sb >> 9) & 1) << 5); R = (st >> 1) * 16 + swz / 64; C = (st & 1) * 32 + (swz % 64) / 2; }
__host__ __device__ __forceinline__ int perm32(int rho) { const int n = rho >> 4, i = rho & 15; return 8 * (i >> 2) + 4 * n + (i & 3); }

struct Unit { int pm, pn; };
struct Gemm { const bf16_t* A; const bf16_t* Bt; int M, N, K; };

struct StaticOrder {
    int nM, nN, nwg, G, c;
    __host__ __device__ void init(int M, int N, int G_, int c_) { nM = M / BM; nN = N / BM; nwg = nM * nN; G = G_; c = c_; }
    __host__ __device__ bool next(int i, Unit& u) const {
        const long L = (long)i * G + c; if (L >= nwg) return false;
        int wgid = (int)L; { const int q = nwg / NXCD, r = nwg % NXCD, xcd = wgid % NXCD, off = wgid / NXCD; wgid = (xcd < r ? xcd * (q + 1) : r * (q + 1) + (xcd - r) * q) + off; }
        const int nig = WGM * nN, gid = wgid / nig, fm = gid * WGM, gsz = (nM - fm) < WGM ? (nM - fm) : WGM;
        u.pm = fm + ((wgid % nig) % gsz); u.pn = (wgid % nig) / gsz; return true;
    }
    __device__ __forceinline__ void a_ready(const Unit&) const {}
    __device__ __forceinline__ void done(const Unit&) const {}
};

template <class Epi, class Sched, bool ALIGN_EPI = false, bool SP2 = false>
__device__ __forceinline__ void gemm_phase(PG8_LAS unsigned char* lds, const Gemm g, const Sched& S, const Epi& E) {
    const int tid = threadIdx.x, wid = __builtin_amdgcn_readfirstlane(tid >> 6), lane = tid & 63, wr = wid >> 2, wc = wid & 3, fr = lane & 15, fq = lane >> 4;
    const int K = g.K, nt = K / BK;
    unsigned voffA[2], voffB[2];
#pragma unroll
    for (int i = 0; i < 2; ++i) { int R, C; stage_rc(tid * 16 + i * 8192, R, C); const int Rb = Epi::PERM ? ((R & ~31) + perm32(R & 31)) : R;
        voffA[i] = (unsigned)(R * K + C) * 2u; voffB[i] = (unsigned)(Rb * K + C) * 2u; }
    const size_t kstep = (size_t)(BK * 2);
    const size_t hstep = (size_t)HALF * K * 2;
    const size_t tstep = 2 * hstep;
    const unsigned ldsw = (unsigned)wid * 1024u;
    const int aoff = lds_byte(wr * 64 + fr, fq * 8), boff = lds_byte(wc * 32 + fr, fq * 8);
#define PG8_SA(b, h) (((b) * 2 + (h)) * HTB)
#define PG8_SB(b, h) ((4 + (b) * 2 + (h)) * HTB)
#define PG8_STAGE(bufoff, gbase, voff) do { _Pragma("unroll") for (int _i = 0; _i < 2; ++_i) \
        __builtin_amdgcn_global_load_lds((const unsigned*)((const char*)(gbase) + (voff)[_i]), (PG8_LAS unsigned*)(lds + (bufoff) + ldsw + _i * 8192), 16, 0, 0); } while (0)
#define PG8_LDA(dst, b, h) do { _Pragma("unroll") for (int m = 0; m < 4; ++m) _Pragma("unroll") for (int k = 0; k < 2; ++k) dst[m][k] = *(const PG8_LAS bf16x8*)(lds + PG8_SA(b, h) + aoff + m * 2048 + k * 1024); } while (0)
#define PG8_LDB(dst, b, h) do { _Pragma("unroll") for (int n = 0; n < 2; ++n) _Pragma("unroll") for (int k = 0; k < 2; ++k) dst[n][k] = *(const PG8_LAS bf16x8*)(lds + PG8_SB(b, h) + boff + n * 2048 + k * 1024); } while (0)
#define PG8_MMA(ai, bj, At, Bt) do { __builtin_amdgcn_s_setprio(1); _Pragma("unroll") for (int m = 0; m < 4; ++m) _Pragma("unroll") for (int n = 0; n < 2; ++n) _Pragma("unroll") for (int k = 0; k < 2; ++k) \
        acc[ai][bj][m][n] = __builtin_amdgcn_mfma_f32_16x16x32_bf16(Bt[n][k], At[m][k], acc[ai][bj][m][n], 0, 0, 0); __builtin_amdgcn_s_setprio(0); } while (0)
#define PG8_WAIT_V(n) asm volatile("s_waitcnt vmcnt(" #n ")" ::: "memory")
#define PG8_WAIT_L(n) asm volatile("s_waitcnt lgkmcnt(" #n ")" ::: "memory")
#define PG8_BAR __builtin_amdgcn_s_barrier()
#define PG8_SCHED __builtin_amdgcn_sched_barrier(0)
    Unit cur, nxt; int ui = 0;
    if (!S.next(0, cur)) return;
    f32x4 acc[2][2][4][2];
#pragma unroll
    for (int a = 0; a < 2; ++a)
#pragma unroll
        for (int b = 0; b < 2; ++b)
#pragma unroll
            for (int m = 0; m < 4; ++m)
#pragma unroll
                for (int n = 0; n < 2; ++n) acc[a][b][m][n] = (f32x4){0.f, 0.f, 0.f, 0.f};
    bf16x8 At[4][2], B0[2][2], B1[2][2];
    const char* cA = (const char*)g.A + (size_t)cur.pm * tstep; const char* cB = (const char*)g.Bt + (size_t)cur.pn * tstep;
    S.a_ready(cur);
    if constexpr (SP2) {
        PG8_STAGE(PG8_SB(0, 0), cB, voffB); PG8_STAGE(PG8_SB(0, 1), cB + hstep, voffB); PG8_STAGE(PG8_SA(0, 0), cA, voffA); PG8_STAGE(PG8_SA(0, 1), cA + hstep, voffA);
        if (wr == 1) PG8_BAR;
        PG8_WAIT_V(2); PG8_BAR;
        PG8_STAGE(PG8_SB(1, 0), cB + kstep, voffB); PG8_STAGE(PG8_SA(1, 0), cA + kstep, voffA); PG8_STAGE(PG8_SB(1, 1), cB + hstep + kstep, voffB);
        PG8_WAIT_V(6); PG8_BAR;
    } else {
        PG8_STAGE(PG8_SB(0, 0), cB, voffB); PG8_STAGE(PG8_SA(0, 0), cA, voffA); PG8_STAGE(PG8_SB(0, 1), cB + hstep, voffB); PG8_STAGE(PG8_SA(0, 1), cA + hstep, voffA);
        if (wr == 1) PG8_BAR;
        PG8_WAIT_V(4); PG8_BAR;
        PG8_STAGE(PG8_SB(1, 0), cB + kstep, voffB); PG8_STAGE(PG8_SA(1, 0), cA + kstep, voffA); PG8_STAGE(PG8_SB(1, 1), cB + hstep + kstep, voffB);
        PG8_WAIT_V(6); PG8_BAR;
    }
    for (;;) {
        const bool has_next = S.next(ui + 1, nxt);
        const char* nA = has_next ? (const char*)g.A + (size_t)nxt.pm * tstep : cA; const char* nB = has_next ? (const char*)g.Bt + (size_t)nxt.pn * tstep : cB;
        for (int t = 0; t < nt; t += 2) {
            const bool last = (t == nt - 2);
            const char* a1 = cA + (size_t)(t + 1) * kstep;
            const char* a2 = last ? nA : cA + (size_t)(t + 2) * kstep; const char* b2 = last ? nB : cB + (size_t)(t + 2) * kstep;
            const char* a3 = a2 + kstep; const char* b3 = b2 + kstep;
            if (last && has_next) S.a_ready(nxt);
            if constexpr (SP2) {
            PG8_LDB(B0, 0, 0); PG8_LDB(B1, 0, 1); PG8_SCHED; PG8_LDA(At, 0, 0); PG8_STAGE(PG8_SA(1, 1), a1 + hstep, voffA);
            PG8_WAIT_V(8); PG8_WAIT_L(0); PG8_BAR; PG8_MMA(0, 0, At, B0); PG8_MMA(0, 1, At, B1); PG8_BAR; PG8_SCHED;
            PG8_LDA(At, 0, 1); PG8_STAGE(PG8_SB(0, 0), b2, voffB); PG8_STAGE(PG8_SB(0, 1), b2 + hstep, voffB); PG8_STAGE(PG8_SA(0, 0), a2, voffA);
            PG8_WAIT_V(8); PG8_WAIT_L(0); PG8_BAR; PG8_MMA(1, 0, At, B0); PG8_MMA(1, 1, At, B1); PG8_BAR; PG8_SCHED;
            PG8_LDB(B0, 1, 0); PG8_LDB(B1, 1, 1); PG8_SCHED; PG8_LDA(At, 1, 0); PG8_STAGE(PG8_SA(0, 1), a2 + hstep, voffA);
            PG8_WAIT_V(8); PG8_WAIT_L(0); PG8_BAR; PG8_MMA(0, 0, At, B0); PG8_MMA(0, 1, At, B1); PG8_BAR; PG8_SCHED;
            PG8_LDA(At, 1, 1); PG8_STAGE(PG8_SB(1, 0), b3, voffB); PG8_STAGE(PG8_SB(1, 1), b3 + hstep, voffB); PG8_STAGE(PG8_SA(1, 0), a3, voffA);
            PG8_WAIT_V(8); PG8_WAIT_L(0); PG8_BAR; PG8_MMA(1, 0, At, B0); PG8_MMA(1, 1, At, B1); PG8_BAR; PG8_SCHED;
            } else {
            PG8_LDB(B0, 0, 0); PG8_SCHED; PG8_LDA(At, 0, 0); PG8_STAGE(PG8_SA(1, 1), a1 + hstep, voffA);
            PG8_WAIT_L(8); PG8_BAR; PG8_WAIT_L(0); PG8_MMA(0, 0, At, B0); PG8_BAR; PG8_SCHED;
            PG8_LDB(B1, 0, 1); PG8_STAGE(PG8_SB(0, 0), b2, voffB);
            PG8_BAR; PG8_WAIT_L(0); PG8_MMA(0, 1, At, B1); PG8_BAR;
            PG8_LDA(At, 0, 1); PG8_STAGE(PG8_SA(0, 0), a2, voffA);
            PG8_BAR; PG8_WAIT_L(0); PG8_MMA(1, 0, At, B0); PG8_BAR; PG8_SCHED;
            PG8_STAGE(PG8_SB(0, 1), b2 + hstep, voffB);
            PG8_WAIT_V(6); PG8_BAR; PG8_MMA(1, 1, At, B1); PG8_BAR;
            PG8_LDB(B0, 1, 0); PG8_SCHED; PG8_LDA(At, 1, 0); PG8_STAGE(PG8_SA(0, 1), a2 + hstep, voffA);
            PG8_WAIT_L(8); PG8_BAR; PG8_WAIT_L(0); PG8_MMA(0, 0, At, B0); PG8_BAR; PG8_SCHED;
            PG8_LDB(B1, 1, 1); PG8_STAGE(PG8_SB(1, 0), b3, voffB);
            PG8_BAR; PG8_WAIT_L(0); PG8_MMA(0, 1, At, B1); PG8_BAR;
            PG8_LDA(At, 1, 1); PG8_STAGE(PG8_SA(1, 0), a3, voffA);
            PG8_BAR; PG8_WAIT_L(0); PG8_MMA(1, 0, At, B0); PG8_BAR; PG8_SCHED;
            PG8_STAGE(PG8_SB(1, 1), b3 + hstep, voffB);
            PG8_WAIT_V(6); PG8_BAR; PG8_MMA(1, 1, At, B1); PG8_BAR;
            }
        }
        if constexpr (ALIGN_EPI) { if (wr == 0) PG8_BAR; }
        if constexpr (!Epi::AFTER_DRAIN) { E(acc, cur, wr, wc, fr, fq); S.done(cur); }
        if (!has_next) break;
#pragma unroll
        for (int a = 0; a < 2; ++a)
#pragma unroll
            for (int b = 0; b < 2; ++b)
#pragma unroll
                for (int m = 0; m < 4; ++m)
#pragma unroll
                    for (int n = 0; n < 2; ++n) acc[a][b][m][n] = (f32x4){0.f, 0.f, 0.f, 0.f};
        cur = nxt; cA = nA; cB = nB; ++ui;
        if constexpr (ALIGN_EPI) { if (wr == 1) PG8_BAR; }
    }
    PG8_WAIT_V(0);
    if constexpr (!ALIGN_EPI) { if (wr == 0) PG8_BAR; }
    PG8_BAR;
    if constexpr (Epi::AFTER_DRAIN) { E.fused(acc, cur, wr, wc, fr, fq, lds, wid, lane); S.done(cur); }
#undef PG8_SA
#undef PG8_SB
#undef PG8_STAGE
#undef PG8_LDA
#undef PG8_LDB
#undef PG8_MMA
#undef PG8_WAIT_V
#undef PG8_WAIT_L
#undef PG8_BAR
#undef PG8_SCHED
}
}

#define GAS __attribute__((address_space(1)))
#define LAS __attribute__((address_space(3)))
#define DI __device__ __forceinline__
typedef unsigned short bf16;
typedef unsigned v4u __attribute__((ext_vector_type(4)));
typedef unsigned v2u __attribute__((ext_vector_type(2)));
typedef float f32x4 __attribute__((ext_vector_type(4)));
typedef float f32x16 __attribute__((ext_vector_type(16)));
typedef short bf16x8 __attribute__((ext_vector_type(8)));
typedef short s16x4 __attribute__((ext_vector_type(4)));
typedef short v4i16_t __attribute__((ext_vector_type(4)));
typedef float f32x2_t __attribute__((ext_vector_type(2)));
typedef __bf16 bf16x2_t __attribute__((ext_vector_type(2)));
typedef GAS unsigned gu32;
#define RLX_AGENT __ATOMIC_RELAXED, __HIP_MEMORY_SCOPE_AGENT
#define LDS_WAIT() asm volatile("s_waitcnt lgkmcnt(0)" ::: "memory")
DI unsigned cvtpk(float lo, float hi) { f32x2_t v = {lo, hi}; bf16x2_t b = __builtin_convertvector(v, bf16x2_t); return __builtin_bit_cast(unsigned, b); }
DI v4u pack8(f32x4 a, f32x4 b) { v4u w; w.x = cvtpk(a[0], a[1]); w.y = cvtpk(a[2], a[3]); w.z = cvtpk(b[0], b[1]); w.w = cvtpk(b[2], b[3]); return w; }
DI v2u pack4(f32x4 a) { v2u w; w.x = cvtpk(a[0], a[1]); w.y = cvtpk(a[2], a[3]); return w; }
DI float bflo(unsigned w) { return __builtin_bit_cast(float, w << 16); }
DI float bfhi(unsigned w) { return __builtin_bit_cast(float, w & 0xffff0000u); }
DI f32x4 unpack4(v2u w) { return (f32x4){bflo(w.x), bfhi(w.x), bflo(w.y), bfhi(w.y)}; }
DI float fexp2(float x) { return __builtin_amdgcn_exp2f(x); }
DI float flog2(float x) { return __builtin_amdgcn_logf(x); }
DI float wave_sum(float v) {
#pragma unroll
    for (int o = 1; o < 64; o <<= 1) v += __shfl_xor(v, o);
    return v;
}
DI float half_max(float v) { auto rr = __builtin_amdgcn_permlane32_swap(__float_as_uint(v), __float_as_uint(v), false, false); return fmaxf(__uint_as_float(rr[0]), __uint_as_float(rr[1])); }
DI float half_sum(float v) { auto rr = __builtin_amdgcn_permlane32_swap(__float_as_uint(v), __float_as_uint(v), false, false); return __uint_as_float(rr[0]) + __uint_as_float(rr[1]); }
#define XB_TMO      128
#define XB_XCNT(j)  (256  + 64 * (j))
#define XB_XSUB(j)  (1280 + 64 * (j))
#define XB_XGEN(j)  (2304 + 64 * (j))
#define XB_TOP      3328
#define XB_TOPGEN   3392
#define XCD_BAR_WORDS 3456
#define XB_SPIN_CAP (1u << 18)

__device__ __forceinline__ unsigned xb_ld(unsigned* p)              { return __hip_atomic_load(p, __ATOMIC_RELAXED, __HIP_MEMORY_SCOPE_AGENT); }
__device__ __forceinline__ unsigned xb_add(unsigned* p, unsigned v) { return __hip_atomic_fetch_add(p, v, __ATOMIC_RELAXED, __HIP_MEMORY_SCOPE_AGENT); }
__device__ __forceinline__ unsigned xb_xcc_id() { return (unsigned)__builtin_amdgcn_s_getreg((3 << 11) | 20) & 0xFu; }
#define XB_SPIN(cond, bar) do { unsigned _sp = 0; while (cond) { __builtin_amdgcn_s_sleep(1); \
    if ((++_sp & 255u) == 0u) { if (xb_ld(&(bar)[XB_TMO])) break; if (_sp > XB_SPIN_CAP) { atomicAdd(&(bar)[XB_TMO], 1u); break; } } } } while (0)

struct XcdBarrier {
    unsigned* bar; unsigned x;
    volatile LAS unsigned* st;
};

__device__ __forceinline__ XcdBarrier xcd_barrier_post(unsigned* bar, volatile LAS unsigned* st) {
    XcdBarrier b; b.bar = bar; b.x = xb_xcc_id(); b.st = st;
    if (threadIdx.x == 0) (void)xb_add(&bar[XB_XCNT(b.x)], 1u);
    return b;
}
__device__ __forceinline__ void xcd_barrier_complete(unsigned* bar, unsigned x, unsigned& nloc, unsigned& nx) {
    const unsigned G = gridDim.x * gridDim.y * gridDim.z;
    unsigned sum, cnt, mine, sp = 0u;
    for (;;) {
        sum = 0u; cnt = 0u; mine = 0u;
#pragma unroll
        for (unsigned j = 0; j < 16; ++j) { const unsigned c = xb_ld(&bar[XB_XCNT(j)]); sum += c; cnt += (c > 0u) ? 1u : 0u; mine = (j == x) ? c : mine; }
        if (sum == G) break;
        __builtin_amdgcn_s_sleep(1);
        if ((++sp & 255u) == 0u) { if (xb_ld(&bar[XB_TMO])) break; if (sp > XB_SPIN_CAP) { atomicAdd(&bar[XB_TMO], 1u); break; } }
    }
    nloc = mine > 0u ? mine : 1u; nx = cnt > 0u ? cnt : 1u;
}

__device__ __forceinline__ void xcd_barrier(const XcdBarrier& b) {
    asm volatile("s_waitcnt vmcnt(0)" ::: "memory");
    __syncthreads();
    if (threadIdx.x == 0) {
        unsigned* bar = b.bar;
        __builtin_amdgcn_s_waitcnt(0);
        unsigned nloc = b.st[0], nx = b.st[1];
        if (nloc == 0u) { xcd_barrier_complete(bar, b.x, nloc, nx); b.st[0] = nloc; b.st[1] = nx; }
        const unsigned old = xb_add(&bar[XB_XSUB(b.x)], 1u);
        const unsigned gen = old / nloc;
        if (old + 1u == (gen + 1u) * nloc) {
            __builtin_amdgcn_fence(__ATOMIC_RELEASE, "agent");
            asm volatile("s_waitcnt vmcnt(0)" ::: "memory");
            const unsigned og = xb_add(&bar[XB_TOP], 1u);
            const unsigned tg = og / nx;
            if (og + 1u == (tg + 1u) * nx) xb_add(&bar[XB_TOPGEN], 1u);
            else XB_SPIN(xb_ld(&bar[XB_TOPGEN]) == tg, bar);
            __builtin_amdgcn_fence(__ATOMIC_ACQUIRE, "agent");
            xb_add(&bar[XB_XGEN(b.x)], 1u);
            asm volatile("s_waitcnt vmcnt(0)" ::: "memory");
        } else {
            XB_SPIN(xb_ld(&bar[XB_XGEN(b.x)]) == gen, bar);
            __builtin_amdgcn_fence(__ATOMIC_ACQUIRE, "agent");
            asm volatile("s_waitcnt vmcnt(0)" ::: "memory");
        }
    }
    __syncthreads();
}

constexpr int D = 1024, SEQ = 8192, NBATCH = 2, MP = NBATCH * SEQ, MS = 512, MT = MP + MS, MMEM = 512, MA = MT + MMEM;
constexpr int NIN = 3584, NBT = 4096, NWAVES = 8, NT = NWAVES * 64;
constexpr int NPM = MT / 256  , NPN_IN = NIN / 256  , NU_IN = NPM * NPN_IN  , NU_P1 = NU_IN + 4;
constexpr float LOG2E = 1.4426950408889634f, QSCALE = 0.125f * LOG2E, RMS_EPS = 1e-6f, NEG = -1e30f;

constexpr size_t O_YP = 0, O_YS = O_YP + (size_t)MP * D, O_PWK = O_YS + (size_t)MS * D, O_PWV = O_PWK + 2 * 2048 * 512, O_PCV = O_PWV + 2 * 2048 * 512,
    O_PMK = O_PCV + 2 * 2 * 256, O_PMV = O_PMK + 2 * 256 * 256, O_SWK = O_PMV + 2 * 256 * 256, O_SWV = O_SWK + 128 * 4 * 512, O_SCV = O_SWV + 128 * 4 * 512,
    O_END = O_SCV + 128 * 2 * 256;

constexpr size_t MiB = 1u << 20;
constexpr size_t WS_CTL = 0, CTL_ZERO_BYTES = 1 * MiB;
constexpr size_t WS_WIN = 2 * MiB, WS_WOUT = 10 * MiB, WS_AH = 16 * MiB, WS_CB = 52 * MiB, WS_U = 62 * MiB, WS_Q = 72 * MiB, WS_K = 90 * MiB, WS_V = 108 * MiB,
    WS_MQ = 126 * MiB, WS_G = 136 * MiB, WS_MK = 170 * MiB, WS_MV = 171 * MiB, WS_OC = 172 * MiB, WS_LSE = 220 * MiB, WS_MIX = 224 * MiB, WS_END = 258 * MiB;
constexpr int CW_BAR = 4096;
constexpr int CW_Q0 = 16384;

constexpr int RING_BYTES = 131072, LDSCTL_OFF = RING_BYTES, MISC_OFF = LDSCTL_OFF + 320, LDS_BYTES = 147456;
constexpr int KP = 144;
constexpr int ATT_K = 0, ATT_V = 384 * KP;

DI void p0_transpose_item(const float* W, int N, int src_col0, bf16* WT, int dst_row0, int k0, LAS float* scr, int lane) {
#pragma unroll 8
    for (int i = 0; i < 32; ++i) { const int kk = 2 * i + (lane >> 5); scr[kk * 33 + (lane & 31)] = W[(size_t)(k0 + kk) * N + src_col0 + (lane & 31)]; }
    LDS_WAIT(); asm volatile("" ::: "memory");
    const int c = lane & 7;
#pragma unroll
    for (int j = 0; j < 4; ++j) { const int n = (lane >> 3) + 8 * j; const LAS float* s = scr + (8 * c) * 33 + n;
        v4u o; o.x = cvtpk(s[0 * 33], s[1 * 33]); o.y = cvtpk(s[2 * 33], s[3 * 33]); o.z = cvtpk(s[4 * 33], s[5 * 33]); o.w = cvtpk(s[6 * 33], s[7 * 33]);
        *(v4u*)(WT + (size_t)(dst_row0 + n) * 1024 + k0 + 8 * c) = o; }
    LDS_WAIT(); asm volatile("" ::: "memory");
}
DI int win_src_col(int n) {
    if (n < 256 || n >= 768) return n;
    const int tile = (n - 256) >> 8, half = ((n - 256) >> 7) & 1, off = n & 127;
    return (half ? 512 : 256) + tile * 128 + off;
}
DI void rms_row_to_bf16(const float* xrow, const float* g, bf16* orow, int lane) {
    const f32x4* xr = (const f32x4*)xrow + lane;
    f32x4 v[4]; float s = 0.f;
#pragma unroll
    for (int j = 0; j < 4; ++j) { v[j] = xr[64 * j]; s += (v[j].x * v[j].x + v[j].y * v[j].y) + (v[j].z * v[j].z + v[j].w * v[j].w); }
    const float r = rsqrtf(wave_sum(s) * (1.f / D) + RMS_EPS);
    const f32x4* gr = (const f32x4*)g + lane;
    v2u* o8 = (v2u*)orow + lane;
#pragma unroll
    for (int j = 0; j < 4; ++j) { const f32x4 gv = gr[64 * j]; o8[64 * j] = pack4(v[j] * r * gv); }
}

struct SchedIn {
    int G, c;
    DI bool next(int i, pg8::Unit& u) const {
        const int L = i * G + c; if (L >= NU_P1) return false;
        if (L >= NU_IN) { const int e = L - NU_IN; u.pm = NPM + (e >> 1); u.pn = NPN_IN + (e & 1); return true; }
        int wgid = L; { const int q = NU_IN / 8, r = NU_IN % 8, xcd = wgid % 8, off = wgid / 8; wgid = (xcd < r ? xcd * (q + 1) : r * (q + 1) + (xcd - r) * q) + off; }
        const int nig = 8 * NPN_IN, gid = wgid / nig, fm = gid * 8, gsz = (NPM - fm) < 8 ? (NPM - fm) : 8;
        u.pm = fm + ((wgid % nig) % gsz); u.pn = (wgid % nig) / gsz; return true;
    }
    DI void a_ready(const pg8::Unit&) const {}
    DI void done(const pg8::Unit&) const {}
};
DI float silu_f(float z) { return z * __builtin_amdgcn_rcpf(1.f + fexp2(-z * LOG2E)); }
struct EpiIn {
    static constexpr bool PERM = true, AFTER_DRAIN = false;
    bf16 *CB, *U, *Q, *K, *V, *MQ, *G, *MK, *MV; float* out;
    DI void operator()(const f32x4 (&acc)[2][2][4][2], const pg8::Unit& u, int wr, int wc, int fr, int fq) const {
        const int pn = u.pn, rb = u.pm * 256 + wr * 64 + fr, cl = wc * 32 + 8 * fq;
        if (pn == 1 || pn == 2) {
            const int col = (pn - 1) * 128 + cl;
#pragma unroll
            for (int ai = 0; ai < 2; ++ai)
#pragma unroll
                for (int m = 0; m < 4; ++m) { const int row = rb + ai * 128 + m * 16;
                    const f32x4 a0 = acc[ai][0][m][0] * acc[ai][1][m][0], a1 = acc[ai][0][m][1] * acc[ai][1][m][1];
                    *(v4u*)(U + (size_t)row * 256 + col) = pack8(a0, a1);
                    float* fo = nullptr;
                    if (row < MP) { const int t = row & (SEQ - 1); if (t >= SEQ - 2) fo = out + O_PCV + ((size_t)((row >> 13) * 2 + (t - (SEQ - 2)))) * 256 + col; }
                    else { const int sr = row - MP, j = sr & 3; if (j >= 2) fo = out + O_SCV + ((size_t)((sr >> 2) * 2 + (j - 2))) * 256 + col; }
                    if (fo) { *(f32x4*)fo = a0; *(f32x4*)(fo + 4) = a1; } }
            return;
        }
        bf16* dst; int ld, c0; float sc = 1.f; int kind = 0;
        size_t o_p = 0, o_s = 0;
        if (pn == 0) { dst = CB; ld = 256; c0 = 0; }
        else if (pn <= 4) { dst = Q; ld = 512; c0 = (pn - 3) * 256; sc = QSCALE; }
        else if (pn <= 6) { dst = K; ld = 512; c0 = (pn - 5) * 256; kind = 1; o_p = O_PWK; o_s = O_SWK; }
        else if (pn <= 8) { dst = V; ld = 512; c0 = (pn - 7) * 256; kind = 1; o_p = O_PWV; o_s = O_SWV; }
        else if (pn == 9) { dst = MQ; ld = 256; c0 = 0; sc = QSCALE; }
        else if (pn <= 13) { dst = G; ld = 1024; c0 = (pn - 10) * 256; kind = 2; }
        else { dst = (pn == 14) ? MK : MV; ld = 256; c0 = 0; kind = 3; o_p = (pn == 14) ? O_PMK : O_PMV; }
#pragma unroll
        for (int ai = 0; ai < 2; ++ai)
#pragma unroll
            for (int m = 0; m < 4; ++m) { const int row = rb + ai * 128 + m * 16;
#pragma unroll
                for (int bj = 0; bj < 2; ++bj) { const int col = c0 + bj * 128 + cl;
                    f32x4 v0 = acc[ai][bj][m][0], v1 = acc[ai][bj][m][1];
                    if (kind == 3) { const int mr = row - MT;
                        *(v4u*)(dst + (size_t)mr * ld + col) = pack8(v0, v1);
                        float* fo = out + o_p + (size_t)mr * 256 + col; *(f32x4*)fo = v0; *(f32x4*)(fo + 4) = v1; continue; }
                    if (kind == 1) { float* fo = nullptr;
                        if (row < MP) { const int t = row & (SEQ - 1); if (t >= SEQ - 2048) fo = out + o_p + ((size_t)((row >> 13) * 2048 + (t - (SEQ - 2048)))) * 512 + col; }
                        else fo = out + o_s + (size_t)(row - MP) * 512 + col;
                        if (fo) { *(f32x4*)fo = v0; *(f32x4*)(fo + 4) = v1; } }
                    if (kind == 2) {
#pragma unroll
                        for (int e = 0; e < 4; ++e) { v0[e] = silu_f(v0[e]); v1[e] = silu_f(v1[e]); } }
                    else { v0 = v0 * sc; v1 = v1 * sc; }
                    *(v4u*)(dst + (size_t)row * ld + col) = pack8(v0, v1); } }
    }
};
struct EpiOut {
    static constexpr bool PERM = true, AFTER_DRAIN = false;
    const float *xp, *xs; float* out;
    DI void operator()(const f32x4 (&acc)[2][2][4][2], const pg8::Unit& u, int wr, int wc, int fr, int fq) const {
        const int rb = u.pm * 256 + wr * 64 + fr, cb = u.pn * 256 + wc * 32 + 8 * fq;
#pragma unroll
        for (int ai = 0; ai < 2; ++ai)
#pragma unroll
            for (int m = 0; m < 4; ++m) { const int row = rb + ai * 128 + m * 16;
                const float* xr = (row < MP) ? xp + (size_t)row * D : xs + (size_t)(row - MP) * D;
                float* orow = out + (size_t)row * D;
#pragma unroll
                for (int bj = 0; bj < 2; ++bj) { const int col = cb + bj * 128;
                    const f32x4 x0 = *(const f32x4*)(xr + col), x1 = *(const f32x4*)(xr + col + 4);
                    *(f32x4*)(orow + col) = x0 + acc[ai][bj][m][0]; *(f32x4*)(orow + col + 4) = x1 + acc[ai][bj][m][1]; } }
    }
};

DI int crow(int r, int hi) { return (r & 3) + 8 * (r >> 2) + 4 * hi; }
DI s16x4 vtr(LAS const unsigned char* p) { return __builtin_bit_cast(s16x4, __builtin_amdgcn_ds_read_tr16_b64_v4i16((LAS v4i16_t*)p)); }
#define MFMA32(a, b, c) __builtin_amdgcn_mfma_f32_32x32x16_bf16((a), (b), (c), 0, 0, 0)

DI void fill_img(LAS unsigned char* img, const bf16* G, long goff0, long gstride, int nkeys, int jmin, int tid) {
#pragma unroll 6
    for (int id = tid; id < nkeys * 8; id += NT) { const int j = id >> 3, ch = id & 7;
        if (j >= jmin) { const v4u v = *(const v4u*)(G + goff0 + (long)j * gstride + ch * 8); *(LAS v4u*)(img + j * KP + ch * 16) = v; } }
}
template <bool BAND>
DI void attn_tile(LAS const unsigned char* kimg, LAS const unsigned char* vimg, int j0, const bf16x8 (&qf)[4], int kdbase, float bstep, int lane,
                  f32x16& o0, f32x16& o1, float& m, float& l) {
    const int qq = lane & 31, hh = lane >> 5;
    f32x16 s;
#pragma unroll
    for (int i = 0; i < 16; ++i) s[i] = 0.f;
    LAS const unsigned char* kp = kimg + (j0 + qq) * KP + 16 * hh;
#pragma unroll
    for (int st = 0; st < 4; ++st) { const bf16x8 kf = *(LAS const bf16x8*)(kp + 32 * st); s = MFMA32(kf, qf[st], s); }
    float tmax = NEG;
#pragma unroll
    for (int r = 0; r < 16; ++r) {
        if (BAND) { const int kd = kdbase + qq - crow(r, hh); const float v = s[r] - bstep * (float)kd; s[r] = (kd < 0 || kd > 128) ? NEG : v; }
        tmax = fmaxf(tmax, s[r]);
    }
    tmax = half_max(tmax);
    const float mn = fmaxf(m, tmax), alpha = fexp2(m - mn);
    float ps = 0.f;
#pragma unroll
    for (int r = 0; r < 16; ++r) { s[r] = fexp2(s[r] - mn); ps += s[r]; }
    ps = half_sum(ps);
    l = l * alpha + ps; m = mn;
#pragma unroll
    for (int i = 0; i < 16; ++i) { o0[i] *= alpha; o1[i] *= alpha; }
    v4u pa, pb;
    pa.x = cvtpk(s[0], s[1]); pa.y = cvtpk(s[2], s[3]); pa.z = cvtpk(s[4], s[5]); pa.w = cvtpk(s[6], s[7]);
    pb.x = cvtpk(s[8], s[9]); pb.y = cvtpk(s[10], s[11]); pb.z = cvtpk(s[12], s[13]); pb.w = cvtpk(s[14], s[15]);
    const bf16x8 p0 = __builtin_bit_cast(bf16x8, pa), p1 = __builtin_bit_cast(bf16x8, pb);
    const int q4 = (lane & 15) >> 2, p = lane & 3, blk = (lane >> 4) & 1;
    LAS const unsigned char* vp = vimg + (j0 + 4 * hh + q4) * KP + 32 * blk + 8 * p;
    {   const s16x4 lo = vtr(vp), hi = vtr(vp + 8 * KP); const bf16x8 vf = __builtin_shufflevector(lo, hi, 0, 1, 2, 3, 4, 5, 6, 7); o0 = MFMA32(vf, p0, o0); }
    {   const s16x4 lo = vtr(vp + 64), hi = vtr(vp + 8 * KP + 64); const bf16x8 vf = __builtin_shufflevector(lo, hi, 0, 1, 2, 3, 4, 5, 6, 7); o1 = MFMA32(vf, p0, o1); }
    {   const s16x4 lo = vtr(vp + 16 * KP), hi = vtr(vp + 24 * KP); const bf16x8 vf = __builtin_shufflevector(lo, hi, 0, 1, 2, 3, 4, 5, 6, 7); o0 = MFMA32(vf, p1, o0); }
    {   const s16x4 lo = vtr(vp + 16 * KP + 64), hi = vtr(vp + 24 * KP + 64); const bf16x8 vf = __builtin_shufflevector(lo, hi, 0, 1, 2, 3, 4, 5, 6, 7); o1 = MFMA32(vf, p1, o1); }
}

DI void unit_dilated(int u, const bf16* Q, const bf16* K, const bf16* V, bf16* OC, float* LSE, LAS unsigned char* lds, int tid, int lane, int wave) {
    const int cfg = u >> 9, rem = u & 511, bh = rem >> 5, blk = rem & 31, b = bh >> 3, h = bh & 7;
    const int lg = 2 * cfg, dil = 1 << lg, nbpr = 32 >> lg, r = blk / nbpr, ib = blk % nbpr, I0 = ib * 256;
    const int jmin = (I0 >= 128) ? 0 : 128 - I0;
    const long goff0 = ((long)b * SEQ + (long)(I0 - 128) * dil + r) * 512 + h * 64, gstride = (long)dil * 512;
    fill_img(lds + ATT_K, K, goff0, gstride, 384, jmin, tid);
    fill_img(lds + ATT_V, V, goff0, gstride, 384, jmin, tid);
    const int qq = lane & 31, hh = lane >> 5;
    const int orow = b * SEQ + (I0 + 32 * wave + qq) * dil + r;
    bf16x8 qf[4];
#pragma unroll
    for (int st = 0; st < 4; ++st) qf[st] = *(const bf16x8*)(Q + (size_t)orow * 512 + h * 64 + 16 * st + 8 * hh);
    __syncthreads();
    f32x16 o0, o1;
#pragma unroll
    for (int i = 0; i < 16; ++i) { o0[i] = 0.f; o1[i] = 0.f; }
    float m = NEG, l = 0.f;
    const float bstep = fexp2(-(float)(h + 1)) * (float)dil * LOG2E;
    for (int a = 0; a < 5; ++a) { const int j0 = 32 * (wave + a); if (j0 < jmin) continue;
        attn_tile<true>(lds + ATT_K, lds + ATT_V, j0, qf, 128 - 32 * a, bstep, lane, o0, o1, m, l); }
    const float inv = 1.f / l;
    bf16* op = OC + ((size_t)cfg * MP + orow) * 512 + h * 64 + 4 * hh;
#pragma unroll
    for (int g = 0; g < 4; ++g) {
        *(v2u*)(op + 8 * g) = pack4((f32x4){o0[4 * g], o0[4 * g + 1], o0[4 * g + 2], o0[4 * g + 3]} * inv);
        *(v2u*)(op + 32 + 8 * g) = pack4((f32x4){o1[4 * g], o1[4 * g + 1], o1[4 * g + 2], o1[4 * g + 3]} * inv);
    }
    if (hh == 0) LSE[((size_t)cfg * MP + orow) * 8 + h] = m + flog2(l);
}
DI void unit_memattn(int u, const bf16* MQ, const bf16* MK, const bf16* MV, const bf16* G, bf16* MIX, LAS unsigned char* lds, int tid, int lane, int wave) {
    const int b = u >> 7, hm = (u >> 5) & 3, qb = u & 31;
    const long goff0 = ((long)b * 256) * 256 + hm * 64;
    fill_img(lds + ATT_K, MK, goff0, 256, 256, 0, tid);
    fill_img(lds + ATT_V, MV, goff0, 256, 256, 0, tid);
    const int qq = lane & 31, hh = lane >> 5;
    const int row = b * SEQ + qb * 256 + 32 * wave + qq;
    bf16x8 qf[4];
#pragma unroll
    for (int st = 0; st < 4; ++st) qf[st] = *(const bf16x8*)(MQ + (size_t)row * 256 + hm * 64 + 16 * st + 8 * hh);
    __syncthreads();
    f32x16 o0, o1;
#pragma unroll
    for (int i = 0; i < 16; ++i) { o0[i] = 0.f; o1[i] = 0.f; }
    float m = NEG, l = 0.f;
    for (int a = 0; a < 8; ++a) attn_tile<false>(lds + ATT_K, lds + ATT_V, 32 * a, qf, 0, 0.f, lane, o0, o1, m, l);
    const float inv = 1.f / l;
    const bf16* gp = G + (size_t)row * D + 768 + hm * 64 + 4 * hh;
    bf16* op = MIX + (size_t)row * D + 768 + hm * 64 + 4 * hh;
#pragma unroll
    for (int g = 0; g < 4; ++g) {
        const f32x4 g0 = unpack4(*(const v2u*)(gp + 8 * g)), g1 = unpack4(*(const v2u*)(gp + 32 + 8 * g));
        *(v2u*)(op + 8 * g) = pack4((f32x4){o0[4 * g], o0[4 * g + 1], o0[4 * g + 2], o0[4 * g + 3]} * inv * g0);
        *(v2u*)(op + 32 + 8 * g) = pack4((f32x4){o1[4 * g], o1[4 * g + 1], o1[4 * g + 2], o1[4 * g + 3]} * inv * g1);
    }
}

DI void unit_sample_attn(int u, const bf16* Q, const float* ckw, const float* cvw, const float* nkw, const float* nvw, const bf16* G, bf16* MIX,
                         LAS unsigned char* lds, int tid, int lane, int wave) {
    const int b = u >> 2, j = u & 3, hd = lane >> 3, srow = MP + u;
    float q[8];
    { const v4u w = *(const v4u*)(Q + (size_t)srow * 512 + lane * 8); q[0] = bflo(w.x); q[1] = bfhi(w.x); q[2] = bflo(w.y); q[3] = bfhi(w.y); q[4] = bflo(w.z); q[5] = bfhi(w.z); q[6] = bflo(w.w); q[7] = bfhi(w.w); }
    const float slope2 = fexp2(-(float)(hd + 1)) * LOG2E;
    const float* ck = ckw + (size_t)b * 2048 * 512 + lane * 8; const float* cv = cvw + (size_t)b * 2048 * 512 + lane * 8;
    const float* nk = nkw + (size_t)b * 4 * 512 + lane * 8;    const float* nv = nvw + (size_t)b * 4 * 512 + lane * 8;
    float m = NEG, l = 0.f, o[8];
#pragma unroll
    for (int e = 0; e < 8; ++e) o[e] = 0.f;
    for (int cfg = 0; cfg < 3; ++cfg) { const int dil = 1 << (2 * cfg); const float bs = slope2 * (float)dil;
        for (int n0 = 0; n0 < 20; n0 += 4) {
            if (wave + 8 * n0 > 128) break;
            f32x4 kv[4][2], vv[4][2]; int kds[4];
#pragma unroll
            for (int i = 0; i < 4; ++i) { int kd = wave + 8 * (n0 + i); kds[i] = kd; if (kd > 128) kd = 128;
                const int idx = 2048 + j - kd * dil;
                const float* kp = (idx < 2048) ? ck + (size_t)idx * 512 : nk + (size_t)(idx - 2048) * 512;
                const float* vp = (idx < 2048) ? cv + (size_t)idx * 512 : nv + (size_t)(idx - 2048) * 512;
                kv[i][0] = *(const f32x4*)kp; kv[i][1] = *(const f32x4*)(kp + 4); vv[i][0] = *(const f32x4*)vp; vv[i][1] = *(const f32x4*)(vp + 4); }
            float s[4];
#pragma unroll
            for (int i = 0; i < 4; ++i) { float d = 0.f;
#pragma unroll
                for (int e = 0; e < 4; ++e) d += q[e] * kv[i][0][e] + q[4 + e] * kv[i][1][e];
                d += __shfl_xor(d, 1); d += __shfl_xor(d, 2); d += __shfl_xor(d, 4);
                s[i] = (kds[i] > 128) ? NEG : d - bs * (float)kds[i]; }
            const float mn = fmaxf(fmaxf(m, fmaxf(s[0], s[1])), fmaxf(s[2], s[3])), alpha = fexp2(m - mn);
            float p[4];
#pragma unroll
            for (int i = 0; i < 4; ++i) p[i] = fexp2(s[i] - mn);
            l = l * alpha + (p[0] + p[1]) + (p[2] + p[3]); m = mn;
#pragma unroll
            for (int e = 0; e < 4; ++e) {
                o[e] = o[e] * alpha + (p[0] * vv[0][0][e] + p[1] * vv[1][0][e]) + (p[2] * vv[2][0][e] + p[3] * vv[3][0][e]);
                o[4 + e] = o[4 + e] * alpha + (p[0] * vv[0][1][e] + p[1] * vv[1][1][e]) + (p[2] * vv[2][1][e] + p[3] * vv[3][1][e]); }
        }
    }
    LAS float* so = (LAS float*)lds;
    LAS float* sm = so + 8 * 512;
    LAS float* sl = sm + 64;
    *(LAS f32x4*)(so + wave * 512 + lane * 8) = (f32x4){o[0], o[1], o[2], o[3]};
    *(LAS f32x4*)(so + wave * 512 + lane * 8 + 4) = (f32x4){o[4], o[5], o[6], o[7]};
    if ((lane & 7) == 0) { sm[wave * 8 + hd] = m; sl[wave * 8 + hd] = l; }
    __syncthreads();
    { const int h2 = tid >> 6; float M = NEG;
#pragma unroll
      for (int w = 0; w < 8; ++w) M = fmaxf(M, sm[w * 8 + h2]);
      float num = 0.f, den = 0.f;
#pragma unroll
      for (int w = 0; w < 8; ++w) { const float f = fexp2(sm[w * 8 + h2] - M); num += f * so[w * 512 + tid]; den += f * sl[w * 8 + h2]; }
      const float g = bflo((unsigned)G[(size_t)srow * D + 256 + tid]);
      const unsigned pk = cvtpk(num / den * g, 0.f);
      MIX[(size_t)srow * D + 256 + tid] = (bf16)(pk & 0xffffu); }
}
DI void unit_sample_mem(int b, const bf16* MQ, const float* cmk, const float* cmv, const bf16* G, bf16* MIX, LAS unsigned char* lds, int tid, int lane, int wave) {
    const int hd = lane >> 4;
    f32x4 q[4];
#pragma unroll
    for (int jj = 0; jj < 4; ++jj) q[jj] = unpack4(*(const v2u*)(MQ + (size_t)(MP + b * 4 + jj) * 256 + lane * 4));
    const float* mk = cmk + (size_t)b * 256 * 256 + lane * 4; const float* mv = cmv + (size_t)b * 256 * 256 + lane * 4;
    float m[4], l[4]; f32x4 o[4];
#pragma unroll
    for (int jj = 0; jj < 4; ++jj) { m[jj] = NEG; l[jj] = 0.f; o[jj] = (f32x4){0.f, 0.f, 0.f, 0.f}; }
    for (int n0 = 0; n0 < 32; n0 += 4) {
        f32x4 kv[4], vv[4];
#pragma unroll
        for (int i = 0; i < 4; ++i) { const int mi = wave + 8 * (n0 + i); kv[i] = *(const f32x4*)(mk + (size_t)mi * 256); vv[i] = *(const f32x4*)(mv + (size_t)mi * 256); }
#pragma unroll
        for (int jj = 0; jj < 4; ++jj) { float s[4];
#pragma unroll
            for (int i = 0; i < 4; ++i) { float d = (q[jj][0] * kv[i][0] + q[jj][1] * kv[i][1]) + (q[jj][2] * kv[i][2] + q[jj][3] * kv[i][3]);
                d += __shfl_xor(d, 1); d += __shfl_xor(d, 2); d += __shfl_xor(d, 4); d += __shfl_xor(d, 8); s[i] = d; }
            const float mn = fmaxf(fmaxf(m[jj], fmaxf(s[0], s[1])), fmaxf(s[2], s[3])), alpha = fexp2(m[jj] - mn);
            const float p0 = fexp2(s[0] - mn), p1 = fexp2(s[1] - mn), p2 = fexp2(s[2] - mn), p3 = fexp2(s[3] - mn);
            l[jj] = l[jj] * alpha + (p0 + p1) + (p2 + p3); m[jj] = mn;
            o[jj] = o[jj] * alpha + (vv[0] * p0 + vv[1] * p1) + (vv[2] * p2 + vv[3] * p3); }
    }
    LAS float* so = (LAS float*)lds;
    LAS float* sm = so + 8 * 1024;
    LAS float* sl = sm + 128;
#pragma unroll
    for (int jj = 0; jj < 4; ++jj) { *(LAS f32x4*)(so + (wave * 4 + jj) * 256 + lane * 4) = o[jj];
        if ((lane & 15) == 0) { sm[(wave * 4 + jj) * 4 + hd] = m[jj]; sl[(wave * 4 + jj) * 4 + hd] = l[jj]; } }
    __syncthreads();
#pragma unroll
    for (int k = 0; k < 2; ++k) { const int idx = tid + NT * k, jj = idx >> 8, e = idx & 255, h2 = e >> 6; float M = NEG;
#pragma unroll
        for (int w = 0; w < 8; ++w) M = fmaxf(M, sm[(w * 4 + jj) * 4 + h2]);
        float num = 0.f, den = 0.f;
#pragma unroll
        for (int w = 0; w < 8; ++w) { const float f = fexp2(sm[(w * 4 + jj) * 4 + h2] - M); num += f * so[(w * 4 + jj) * 256 + e]; den += f * sl[(w * 4 + jj) * 4 + h2]; }
        const size_t srow = (size_t)(MP + b * 4 + jj);
        const float g = bflo((unsigned)G[srow * D + 768 + e]);
        MIX[srow * D + 768 + e] = (bf16)(cvtpk(num / den * g, 0.f) & 0xffffu); }
}

DI void p2b_row(int row, const bf16* CB, const bf16* U, const bf16* G, const bf16* OC, const float* LSE, const float* cconv, const f32x4 (&cw)[3], bf16* MIX, int lane) {
    const f32x4 cb = unpack4(*(const v2u*)(CB + (size_t)row * 256 + lane * 4));
    const f32x4 u0 = unpack4(*(const v2u*)(U + (size_t)row * 256 + lane * 4));
    f32x4 u1 = (f32x4){0.f, 0.f, 0.f, 0.f}, u2 = u1;
    if (row < MP) { const int t = row & (SEQ - 1);
        if (t >= 1) u1 = unpack4(*(const v2u*)(U + (size_t)(row - 1) * 256 + lane * 4));
        if (t >= 2) u2 = unpack4(*(const v2u*)(U + (size_t)(row - 2) * 256 + lane * 4));
    } else { const int sr = row - MP, b = sr >> 2, j = sr & 3;
        u1 = (j >= 1) ? unpack4(*(const v2u*)(U + (size_t)(row - 1) * 256 + lane * 4)) : *(const f32x4*)(cconv + ((size_t)b * 2 + 1) * 256 + lane * 4);
        u2 = (j >= 2) ? unpack4(*(const v2u*)(U + (size_t)(row - 2) * 256 + lane * 4)) : *(const f32x4*)(cconv + ((size_t)b * 2 + j) * 256 + lane * 4);
    }
    const f32x4 g0 = unpack4(*(const v2u*)(G + (size_t)row * D + lane * 4));
    *(v2u*)(MIX + (size_t)row * D + lane * 4) = pack4(cb * (cw[0] * u2 + cw[1] * u1 + cw[2] * u0) * g0);
    if (row < MP) {
        const int hd = lane >> 3;
        const float l0 = LSE[((size_t)0 * MP + row) * 8 + hd], l1 = LSE[((size_t)1 * MP + row) * 8 + hd], l2 = LSE[((size_t)2 * MP + row) * 8 + hd];
        const float M = fmaxf(l0, fmaxf(l1, l2)), w0 = fexp2(l0 - M), w1 = fexp2(l1 - M), w2 = fexp2(l2 - M), inv = 1.f / (w0 + w1 + w2);
        const v4u a = *(const v4u*)(OC + ((size_t)0 * MP + row) * 512 + lane * 8), b = *(const v4u*)(OC + ((size_t)1 * MP + row) * 512 + lane * 8), c = *(const v4u*)(OC + ((size_t)2 * MP + row) * 512 + lane * 8);
        const v4u gg = *(const v4u*)(G + (size_t)row * D + 256 + lane * 8);
        v4u o;
#pragma unroll
        for (int e = 0; e < 4; ++e) {
            const float lo = (w0 * bflo(a[e]) + w1 * bflo(b[e]) + w2 * bflo(c[e])) * inv * bflo(gg[e]);
            const float hi = (w0 * bfhi(a[e]) + w1 * bfhi(b[e]) + w2 * bfhi(c[e])) * inv * bfhi(gg[e]);
            o[e] = cvtpk(lo, hi); }
        *(v4u*)(MIX + (size_t)row * D + 256 + lane * 8) = o;
    }
}
DI void p4_row(float* yrow, const float* g, int lane) {
    f32x4* xr = (f32x4*)yrow + lane;
    f32x4 v[4]; float s = 0.f;
#pragma unroll
    for (int j = 0; j < 4; ++j) { v[j] = xr[64 * j]; s += (v[j].x * v[j].x + v[j].y * v[j].y) + (v[j].z * v[j].z + v[j].w * v[j].w); }
    const float r = rsqrtf(wave_sum(s) * (1.f / D) + RMS_EPS);
    const f32x4* gr = (const f32x4*)g + lane;
#pragma unroll
    for (int j = 0; j < 4; ++j) xr[64 * j] = v[j] * r * gr[64 * j];
}

#ifndef MK_N_LAUNCHES
#define MK_N_LAUNCHES 6
#endif
constexpr int N_LAUNCHES = MK_N_LAUNCHES, N_PHASES = 6;
struct Args { const float* in[15]; float* out; unsigned char* ws; int ph_lo, ph_hi; };
static_assert(sizeof(Args) == 17 * 8 + 8, "Args has no padding bytes");

DI int q_next(gu32* ctr, volatile LAS int* slot, int tid) {
    __syncthreads();
    if (tid == 0) *slot = (int)__hip_atomic_fetch_add(ctr, 1u, RLX_AGENT);
    __syncthreads();
    return *slot;
}

__global__ void __launch_bounds__(NT, 2) fwd(Args args) {
    extern __shared__ __attribute__((aligned(16))) unsigned char lds_raw[];
    LAS unsigned char* lds = (LAS unsigned char*)lds_raw;
    volatile LAS unsigned* MISC = (volatile LAS unsigned*)(lds + MISC_OFF);
    const int tid = threadIdx.x, lane = tid & 63, wave = __builtin_amdgcn_readfirstlane(tid >> 6);
    const int G = gridDim.x, bx = blockIdx.x;
    unsigned char* ws = args.ws;
    gu32* ctl = (gu32*)(ws + WS_CTL);
    float* out = args.out;
    bf16 *WT_IN = (bf16*)(ws + WS_WIN), *WT_OUT = (bf16*)(ws + WS_WOUT), *AH = (bf16*)(ws + WS_AH), *CB = (bf16*)(ws + WS_CB), *UB = (bf16*)(ws + WS_U),
         *QB = (bf16*)(ws + WS_Q), *KB = (bf16*)(ws + WS_K), *VB = (bf16*)(ws + WS_V), *MQB = (bf16*)(ws + WS_MQ), *GB = (bf16*)(ws + WS_G),
         *MKB = (bf16*)(ws + WS_MK), *MVB = (bf16*)(ws + WS_MV), *OC = (bf16*)(ws + WS_OC), *MIX = (bf16*)(ws + WS_MIX);
    float* LSE = (float*)(ws + WS_LSE);
    for (int u = tid; u < (LDS_BYTES - LDSCTL_OFF) / 4; u += NT) ((LAS unsigned*)(lds + LDSCTL_OFF))[u] = 0u;
    __syncthreads();
    XcdBarrier bar; bar.bar = (unsigned*)(ctl + CW_BAR); bar.x = 0; bar.st = nullptr;
    if (N_LAUNCHES != N_PHASES) bar = xcd_barrier_post((unsigned*)(ctl + CW_BAR), MISC + 8);
    const int lo = args.ph_lo, hi = args.ph_hi;
#define IN(k) (lo <= (k) && (k) < hi)
#define SEAM(k) do { if (IN(k) && IN((k) + 1)) xcd_barrier(bar); } while (0)
    const int gw = bx * NWAVES + wave, NGW = G * NWAVES;

    if (IN(0)) {
        LAS float* scr = (LAS float*)(lds + wave * 16384);
        constexpr int IT_IN = (NBT / 32) * 16, IT_OUT = (D / 32) * 16;
        for (int it = gw; it < IT_IN + IT_OUT; it += NGW) {
            if (it < IT_IN) { const int kb = it / (NBT / 32), nb = it % (NBT / 32), n0 = 32 * nb;
                if (n0 < NIN) p0_transpose_item(args.in[9], NIN, win_src_col(n0), WT_IN, n0, 64 * kb, scr, lane);
                else p0_transpose_item(args.in[12], 512, n0 - NIN, WT_IN, n0, 64 * kb, scr, lane);
            } else { const int r = it - IT_IN, kb = r / (D / 32), nb = r % (D / 32);
                p0_transpose_item(args.in[13], D, 32 * nb, WT_OUT, 32 * nb, 64 * kb, scr, lane); }
        }
        for (int mrow = gw; mrow < MA; mrow += NGW) {
            const float* xr = (mrow < MP) ? args.in[0] + (size_t)mrow * D : (mrow < MT) ? args.in[1] + (size_t)(mrow - MP) * D : args.in[2] + (size_t)(mrow - MT) * D;
            rms_row_to_bf16(xr, (mrow < MT) ? args.in[8] : args.in[11], AH + (size_t)mrow * D, lane);
        }
    }
    SEAM(0);
    if (IN(1)) {
        pg8::Gemm g{AH, WT_IN, MA, NBT, D}; SchedIn S{G, bx};
        EpiIn E{CB, UB, QB, KB, VB, MQB, GB, MKB, MVB, out};
        pg8::gemm_phase<EpiIn, SchedIn, true, true>(lds, g, S, E);
    }
    SEAM(1);
    if (IN(2)) {
        volatile LAS int* slot = (volatile LAS int*)(MISC + 16);
        for (;;) { const int u = q_next(ctl + CW_Q0, slot, tid); if (u >= 512) break;
            unit_sample_attn(u, QB, args.in[3], args.in[4], out + O_SWK, out + O_SWV, GB, MIX, lds, tid, lane, wave); }
        for (;;) { const int u = q_next(ctl + CW_Q0 + 64, slot, tid); if (u >= 128) break;
            unit_sample_mem(u, MQB, args.in[6], args.in[7], GB, MIX, lds, tid, lane, wave); }
        for (;;) { const int u = q_next(ctl + CW_Q0 + 128, slot, tid); if (u >= 1536) break;
            unit_dilated(u, QB, KB, VB, OC, LSE, lds, tid, lane, wave); }
        for (;;) { const int u = q_next(ctl + CW_Q0 + 192, slot, tid); if (u >= 256) break;
            unit_memattn(u, MQB, MKB, MVB, GB, MIX, lds, tid, lane, wave); }
    }
    SEAM(2);
    if (IN(3)) {
        f32x4 cw[3];
#pragma unroll
        for (int k = 0; k < 3; ++k) cw[k] = *(const f32x4*)(args.in[10] + k * 256 + lane * 4);
        for (int row = gw; row < MT; row += NGW) p2b_row(row, CB, UB, GB, OC, LSE, args.in[5], cw, MIX, lane);
    }
    SEAM(3);
    if (IN(4)) {
        pg8::Gemm g{MIX, WT_OUT, MT, D, D}; pg8::StaticOrder S; S.init(MT, D, G, bx);
        EpiOut E{args.in[0], args.in[1], out};
        pg8::gemm_phase<EpiOut, pg8::StaticOrder, true, true>(lds, g, S, E);
    }
    SEAM(4);
    if (IN(5)) {
        for (int row = gw; row < MT; row += NGW) p4_row(out + (size_t)row * D, args.in[14], lane);
    }
#undef IN
#undef SEAM
}

extern "C" void kernel_launch(void* const* d_in, const int* in_sizes, int n_in, void* d_out, int out_size, void* d_ws, size_t ws_size, hipStream_t stream) {
    static int grid = 0;
    if (grid == 0) {
        if (n_in != 15 || (size_t)out_size != O_END || ws_size < WS_END) { fprintf(stderr, "kernel_launch: unexpected sizes: n_in %d out %d (want %zu) ws %zu (want >= %zu); nothing launched\n", n_in, out_size, (size_t)O_END, ws_size, (size_t)WS_END); grid = -1; return; }
        int dev = 0, cus = 0, per_cu = 0;
        if (hipGetDevice(&dev) != hipSuccess || hipDeviceGetAttribute(&cus, hipDeviceAttributeMultiprocessorCount, dev) != hipSuccess) { fprintf(stderr, "kernel_launch: device query failed\n"); grid = -1; return; }
        if (hipFuncSetAttribute((const void*)fwd, hipFuncAttributeMaxDynamicSharedMemorySize, LDS_BYTES) != hipSuccess) { fprintf(stderr, "kernel_launch: hipFuncSetAttribute failed\n"); grid = -1; return; }
        if (hipOccupancyMaxActiveBlocksPerMultiprocessor(&per_cu, (const void*)fwd, NT, LDS_BYTES) != hipSuccess || per_cu < 1)
            fprintf(stderr, "kernel_launch: note: occupancy query reports %d workgroups per CU\n", per_cu);
        (void)hipGetLastError();
        grid = cus;
    }
    if (grid < 0) return;
    if (hipMemsetAsync((char*)d_ws + WS_CTL, 0, CTL_ZERO_BYTES, stream) != hipSuccess) { fprintf(stderr, "kernel_launch: memset failed\n"); return; }
    Args a{};
    for (int i = 0; i < 15; ++i) a.in[i] = (const float*)d_in[i];
    a.out = (float*)d_out; a.ws = (unsigned char*)d_ws;
    if (N_LAUNCHES == 1) { a.ph_lo = 0; a.ph_hi = N_PHASES; hipLaunchKernelGGL(fwd, dim3(grid), dim3(NT), LDS_BYTES, stream, a); }
    else for (int li = 0; li < N_PHASES; ++li) { a.ph_lo = li; a.ph_hi = li + 1; hipLaunchKernelGGL(fwd, dim3(grid), dim3(NT), LDS_BYTES, stream, a); }
    const hipError_t le = hipPeekAtLastError();
    if (le != hipSuccess) fprintf(stderr, "kernel_launch: launch failed: %s\n", hipGetErrorName(le));
}
```
